# Optimizing an MI355X kernel written in HIP

```python
import math
import jax, jax.numpy as jnp
from jax import lax
import numpy as np

D_MODEL = 1024
BATCH = 4
SEQ = 4096
DEPTH = 1

MIX_WIDTH = 2 * D_MODEL
HEAD_DIM = 64
SSD_WIDTH = MIX_WIDTH // 2
SSD_HEADS = SSD_WIDTH // HEAD_DIM
SSD_GROUPS = 2
SSD_STATE = 128
SSD_CHUNK = 128
CONV_K = 4
CONV_DIM = SSD_WIDTH + 2 * SSD_GROUPS * SSD_STATE
ATTN_WIDTH = MIX_WIDTH - SSD_WIDTH
ATTN_HEADS = ATTN_WIDTH // HEAD_DIM
ATTN_KV_HEADS = ATTN_HEADS // 8
WINDOW = 128
ATTN_BLOCK = WINDOW
D_FF = 4 * D_MODEL
PROJ_WIDTH = SSD_WIDTH + CONV_DIM + SSD_HEADS + ATTN_WIDTH + 2 * ATTN_KV_HEADS * HEAD_DIM
ALPHA = (2.0 * DEPTH) ** 0.25
BETA = (8.0 * DEPTH) ** -0.25
LN_EPS = 1e-5
RMS_EPS = 1e-5

kernel_name = "hymba_ssd_swa_sink_alibi_deepnorm_adaln"


def layer_norm(x, g, b):
    xf = x.astype(jnp.float32)
    mu = jnp.mean(xf, axis=-1, keepdims=True)
    var = jnp.mean(jnp.square(xf - mu), axis=-1, keepdims=True)
    return ((xf - mu) * lax.rsqrt(var + LN_EPS)).astype(x.dtype) * g + b


def gated_group_rmsnorm(y, z, w):
    bsz, L, _ = y.shape
    h = (y * jax.nn.silu(z)).astype(jnp.float32).reshape(bsz, L, SSD_GROUPS, -1)
    h = h * lax.rsqrt(jnp.mean(jnp.square(h), axis=-1, keepdims=True) + RMS_EPS)
    return h.reshape(bsz, L, -1).astype(y.dtype) * w


def causal_dwconv(u, w, b):
    K = w.shape[0]
    y = lax.conv_general_dilated(u, w[:, None, :].astype(u.dtype), window_strides=(1,),
                                 padding=[(K - 1, 0)], dimension_numbers=("NWC", "WIO", "NWC"),
                                 feature_group_count=u.shape[-1])
    return y + b


def segsum(a):
    T = a.shape[-1]
    ae = jnp.broadcast_to(a[..., None], a.shape + (T,))
    ae = jnp.where(jnp.tril(jnp.ones((T, T), dtype=bool), k=-1), ae, 0.0)
    cs = jnp.cumsum(ae, axis=-2)
    return jnp.where(jnp.tril(jnp.ones((T, T), dtype=bool), k=0), cs, -jnp.inf)


def ssd_chunked(xs, dt, A, Bm, Cm):
    b, L, H, P = xs.shape
    G, N = Bm.shape[2], Bm.shape[3]
    R = H // G
    T = SSD_CHUNK
    nc = L // T
    X = (xs * dt[..., None]).reshape(b, nc, T, G, R, P)
    a = jnp.transpose((dt * A).reshape(b, nc, T, G, R), (0, 3, 4, 1, 2))
    a_cum = jnp.cumsum(a, axis=-1)
    Lm = jnp.exp(segsum(a))
    Bc = Bm.reshape(b, nc, T, G, N)
    Cc = Cm.reshape(b, nc, T, G, N)
    cb = jnp.einsum("bclgn,bcsgn->bcgls", Cc, Bc)
    y_diag = jnp.einsum("bcgls,bgrcls,bcsgrp->bclgrp", cb, Lm, X)
    decay_states = jnp.exp(a_cum[..., -1:] - a_cum)
    states = jnp.einsum("bclgn,bgrcl,bclgrp->bcgrpn", Bc, decay_states, X)
    chunk_decay = jnp.exp(a_cum[..., -1])

    def step(S, inp):
        st, dec = inp
        return S * dec[..., None, None] + st, S

    S0 = jnp.zeros((b, G, R, P, N), dtype=X.dtype)
    _, prev = lax.scan(step, S0, (jnp.moveaxis(states, 1, 0), jnp.moveaxis(chunk_decay, -1, 0)))
    prev = jnp.moveaxis(prev, 0, 1)
    y_off = jnp.einsum("bclgn,bcgrpn,bgrcl->bclgrp", Cc, prev, jnp.exp(a_cum))
    return (y_diag + y_off).reshape(b, L, H, P)


def alibi_slopes(n):
    def pow2(m):
        start = 2.0 ** (-8.0 / m)
        return [start ** (i + 1) for i in range(m)]
    if math.log2(n).is_integer():
        s = pow2(n)
    else:
        c = 2 ** math.floor(math.log2(n))
        s = pow2(c) + pow2(2 * c)[0::2][: n - c]
    return jnp.asarray(np.array(s, dtype=np.float32))


def swa_sink_alibi(q, k, v, sinks):
    b, L, H, d = q.shape
    KV = k.shape[2]
    R = H // KV
    W = ATTN_BLOCK
    nb = L // W
    qb = q.reshape(b, nb, W, KV, R, d)
    kb = k.reshape(b, nb, W, KV, d)
    vb = v.reshape(b, nb, W, KV, d)
    prev = lambda t: jnp.concatenate([jnp.zeros_like(t[:, :1]), t[:, :-1]], axis=1)
    kk = jnp.concatenate([prev(kb), kb], axis=2)
    vv = jnp.concatenate([prev(vb), vb], axis=2)
    s = jnp.einsum("bnqkrd,bnskd->bnkrqs", qb, kk).astype(jnp.float32) * (d ** -0.5)
    dist = jnp.arange(W)[:, None] + W - jnp.arange(2 * W)[None, :]
    key_pos = jnp.arange(nb)[:, None] * W + jnp.arange(2 * W)[None, :] - W
    valid = ((dist >= 0) & (dist < WINDOW))[None] & (key_pos >= 0)[:, None, :]
    slopes = alibi_slopes(H).reshape(KV, R)
    s = s - slopes[:, :, None, None] * dist.astype(jnp.float32)
    s = jnp.where(valid[None, :, None, None], s, -jnp.inf)
    sink = sinks.astype(jnp.float32).reshape(KV, R)[:, :, None]
    m = jnp.maximum(jnp.max(s, axis=-1), sink)
    p = jnp.exp(s - m[..., None])
    denom = jnp.sum(p, axis=-1) + jnp.exp(sink - m)
    p = (p / denom[..., None]).astype(v.dtype)
    o = jnp.einsum("bnkrqs,bnskd->bnqkrd", p, vv)
    return o.reshape(b, L, H * d)


def hybrid_mixer(u, w_in, conv_w, conv_b, dt_bias, a_log, d_skip, norm_w, sinks, w_out):
    bsz, L, _ = u.shape
    proj = u @ w_in
    i1 = SSD_WIDTH
    i2 = i1 + CONV_DIM
    i3 = i2 + SSD_HEADS
    i4 = i3 + ATTN_WIDTH
    i5 = i4 + ATTN_KV_HEADS * HEAD_DIM
    z, xbc, dt_raw, q, k, v = jnp.split(proj, [i1, i2, i3, i4, i5], axis=-1)
    xbc = jax.nn.silu(causal_dwconv(xbc, conv_w, conv_b))
    xs, Bm, Cm = jnp.split(xbc, [SSD_WIDTH, SSD_WIDTH + SSD_GROUPS * SSD_STATE], axis=-1)
    f32 = jnp.float32
    dt = jax.nn.softplus(dt_raw.astype(f32) + dt_bias.astype(f32))
    A = -jnp.exp(a_log.astype(f32))
    xs_h = xs.astype(f32).reshape(bsz, L, SSD_HEADS, HEAD_DIM)
    y = ssd_chunked(xs_h, dt, A,
                    Bm.astype(f32).reshape(bsz, L, SSD_GROUPS, SSD_STATE),
                    Cm.astype(f32).reshape(bsz, L, SSD_GROUPS, SSD_STATE))
    y = y + d_skip.astype(f32)[:, None] * xs_h
    y = gated_group_rmsnorm(y.reshape(bsz, L, SSD_WIDTH).astype(u.dtype), z, norm_w)
    o = swa_sink_alibi(q.reshape(bsz, L, ATTN_HEADS, HEAD_DIM),
                       k.reshape(bsz, L, ATTN_KV_HEADS, HEAD_DIM),
                       v.reshape(bsz, L, ATTN_KV_HEADS, HEAD_DIM), sinks)
    return jnp.concatenate([y, o.astype(y.dtype)], axis=-1) @ w_out


def setup_inputs(seed: int = 0) -> dict:
    key = jax.random.key(seed)
    ks = jax.random.split(key, 24)
    nrm = lambda k, shape, s: jax.random.normal(k, shape, jnp.float32) * s
    Dp = DEPTH
    dt0 = jnp.exp(jax.random.uniform(ks[10], (Dp, SSD_HEADS), jnp.float32,
                                     math.log(1e-3), math.log(1e-1)))
    dt_bias = dt0 + jnp.log(-jnp.expm1(-dt0))
    a_log = jnp.log(jax.random.uniform(ks[11], (Dp, SSD_HEADS), jnp.float32, 1.0, 16.0))
    return {
        "x": nrm(ks[0], (BATCH, SEQ, D_MODEL), 1.0),
        "c": nrm(ks[1], (BATCH, D_MODEL), 1.0),
        "ln_in_g": 1.0 + nrm(ks[2], (D_MODEL,), 0.02),
        "ln_in_b": nrm(ks[3], (D_MODEL,), 0.02),
        "ada_w": nrm(ks[4], (Dp, D_MODEL, 6 * D_MODEL), 0.1 * D_MODEL ** -0.5),
        "ada_b": nrm(ks[5], (Dp, 6 * D_MODEL), 0.02),
        "w_in": nrm(ks[6], (Dp, D_MODEL, PROJ_WIDTH), D_MODEL ** -0.5),
        "conv_w": nrm(ks[7], (Dp, CONV_K, CONV_DIM), CONV_K ** -0.5),
        "conv_b": nrm(ks[8], (Dp, CONV_DIM), 0.02),
        "dt_bias": dt_bias,
        "a_log": a_log,
        "d_skip": 1.0 + nrm(ks[12], (Dp, SSD_HEADS), 0.1),
        "ssd_norm_w": 1.0 + nrm(ks[13], (Dp, SSD_WIDTH), 0.02),
        "attn_sinks": nrm(ks[14], (Dp, ATTN_HEADS), 0.5),
        "w_out": nrm(ks[15], (Dp, MIX_WIDTH, D_MODEL), BETA * MIX_WIDTH ** -0.5),
        "ln1_g": 1.0 + nrm(ks[16], (Dp, D_MODEL), 0.02),
        "ln1_b": nrm(ks[17], (Dp, D_MODEL), 0.02),
        "w_ff1": nrm(ks[18], (Dp, D_MODEL, D_FF), D_MODEL ** -0.5),
        "b_ff1": nrm(ks[19], (Dp, D_FF), 0.02),
        "w_ff2": nrm(ks[20], (Dp, D_FF, D_MODEL), BETA * D_FF ** -0.5),
        "b_ff2": nrm(ks[21], (Dp, D_MODEL), 0.02),
        "ln2_g": 1.0 + nrm(ks[22], (Dp, D_MODEL), 0.02),
        "ln2_b": nrm(ks[23], (Dp, D_MODEL), 0.02),
    }


def reference(x, c, ln_in_g, ln_in_b, ada_w, ada_b, w_in, conv_w, conv_b, dt_bias, a_log, d_skip,
              ssd_norm_w, attn_sinks, w_out, ln1_g, ln1_b, w_ff1, b_ff1, w_ff2, b_ff2, ln2_g, ln2_b):
    h = layer_norm(x, ln_in_g, ln_in_b)
    cs = jax.nn.silu(c)
    for l in range(DEPTH):
        mod = cs @ ada_w[l] + ada_b[l]
        sh1, sc1, g1, sh2, sc2, g2 = jnp.split(mod[:, None, :], 6, axis=-1)
        u = h * (1.0 + sc1) + sh1
        mix = hybrid_mixer(u, w_in[l], conv_w[l], conv_b[l], dt_bias[l], a_log[l], d_skip[l],
                           ssd_norm_w[l], attn_sinks[l], w_out[l])
        h = layer_norm(ALPHA * h + (1.0 + g1) * mix, ln1_g[l], ln1_b[l])
        u = h * (1.0 + sc2) + sh2
        f = jnp.square(jax.nn.relu(u @ w_ff1[l] + b_ff1[l])) @ w_ff2[l] + b_ff2[l]
        h = layer_norm(ALPHA * h + (1.0 + g2) * f, ln2_g[l], ln2_b[l])
    return h
```

```cpp
#include <hip/hip_runtime.h>
#include <cstdio>
#include <cstdint>

typedef unsigned short bf16;
constexpr int NB = 4, L = 4096, M = NB * L, D = 1024, DFF = 4096;
constexpr int PROJ = 3856, NP = 3840, CONVD = 1536, NH = 16, HD = 64, NST = 128, CH = 128, NCH = L / CH;
constexpr float LN_EPS = 1e-5f, RMS_EPS = 1e-5f;
constexpr float ALPHA = 1.18920711500272f;
constexpr float LOG2E = 1.4426950408889634f;
constexpr float QSCALE = 0.125f * LOG2E;

constexpr size_t MiB = 1u << 20;
constexpr size_t WS_CTL = 0, WS_MOD = 1 * MiB, WS_STATS = 1 * MiB + 128 * 1024, WS_DT = 2 * MiB;
constexpr size_t WS_WIN = 4 * MiB, WS_WOUT = 12 * MiB, WS_WFF1 = 16 * MiB, WS_WFF2 = 24 * MiB;
constexpr size_t WS_U = 32 * MiB, WS_SPREV = 32 * MiB;
constexpr size_t WS_Z = 64 * MiB, WS_XBC = 96 * MiB, WS_Q = 144 * MiB, WS_KV = 176 * MiB, WS_CB = 184 * MiB;
constexpr size_t WS_YO = 192 * MiB, WS_F1 = 64 * MiB, WS_MIX = 64 * MiB, WS_F = 192 * MiB, WS_END = 256 * MiB;

__device__ __forceinline__ float bf2f(bf16 v) { return __uint_as_float((unsigned)v << 16); }
__device__ __forceinline__ bf16 f2bf(float f) { unsigned u = __float_as_uint(f); return (bf16)((u + 0x7fffu + ((u >> 16) & 1u)) >> 16); }
__device__ __forceinline__ float silu_f(float x) { return x / (1.f + __expf(-x)); }
__device__ __forceinline__ float softplus_f(float x) { return fmaxf(x, 0.f) + log1pf(__expf(-fabsf(x))); }
__device__ __forceinline__ float wave_sum(float v) {
#pragma unroll
    for (int o = 1; o < 64; o <<= 1) v += __shfl_xor(v, o);
    return v;
}
__device__ __forceinline__ float wave_max(float v) {
#pragma unroll
    for (int o = 1; o < 64; o <<= 1) v = fmaxf(v, __shfl_xor(v, o));
    return v;
}

__global__ void __launch_bounds__(256) k_wt(const float* __restrict__ W, int K, int N, bf16* __restrict__ Wt, int NR, int split, int shift, const float* __restrict__ kscale, int kscale_n) {
    const size_t idx = (size_t)blockIdx.x * blockDim.x + threadIdx.x;
    if (idx >= (size_t)NR * K) return;
    const int k = (int)(idx / NR), r = (int)(idx % NR);
    const int col = r < split ? r : r + shift;
    float v = W[(size_t)k * N + col];
    if (kscale && k < kscale_n) v *= kscale[k];
    Wt[(size_t)r * K + k] = f2bf(v);
}
__global__ void __launch_bounds__(256) k_ada(const float* __restrict__ c, const float* __restrict__ ada_w, const float* __restrict__ ada_b, float* __restrict__ mod) {
    const int j = blockIdx.x * blockDim.x + threadIdx.x;
    if (j >= 6 * D) return;
    float a0 = 0.f, a1 = 0.f, a2 = 0.f, a3 = 0.f;
    for (int k = 0; k < D; ++k) {
        const float w = ada_w[(size_t)k * 6 * D + j];
        a0 += silu_f(c[k]) * w; a1 += silu_f(c[D + k]) * w; a2 += silu_f(c[2 * D + k]) * w; a3 += silu_f(c[3 * D + k]) * w;
    }
    const float bb = ada_b[j];
    mod[j] = a0 + bb; mod[6 * D + j] = a1 + bb; mod[12 * D + j] = a2 + bb; mod[18 * D + j] = a3 + bb;
}
__global__ void __launch_bounds__(256) k_ln_in(const float* __restrict__ x, const float* __restrict__ g, const float* __restrict__ bt, const float* __restrict__ mod,
                        const float* __restrict__ w_in, const float* __restrict__ dt_bias, bf16* __restrict__ U, float* __restrict__ stats, float* __restrict__ DT) {
    const int row = blockIdx.x * 4 + (threadIdx.x >> 6), lane = threadIdx.x & 63, b = row / L;
    const float* xr = x + (size_t)row * D;
    float v[16]; float s = 0.f;
#pragma unroll
    for (int j = 0; j < 4; ++j) { const float4 t = *(const float4*)(xr + j * 256 + lane * 4); v[4 * j] = t.x; v[4 * j + 1] = t.y; v[4 * j + 2] = t.z; v[4 * j + 3] = t.w; s += (t.x + t.y) + (t.z + t.w); }
    const float mean = wave_sum(s) * (1.f / D); float s2 = 0.f;
#pragma unroll
    for (int i = 0; i < 16; ++i) { v[i] -= mean; s2 += v[i] * v[i]; }
    const float rstd = rsqrtf(wave_sum(s2) * (1.f / D) + LN_EPS);
    if (lane == 0) { stats[2 * row] = mean; stats[2 * row + 1] = rstd; }
    const float* sh1 = mod + (size_t)b * 6 * D; const float* sc1 = sh1 + D;
    float dacc[16];
#pragma unroll
    for (int j = 0; j < 16; ++j) dacc[j] = 0.f;
#pragma unroll
    for (int j = 0; j < 4; ++j) {
        float u4[4];
#pragma unroll
        for (int e = 0; e < 4; ++e) { const int c = j * 256 + lane * 4 + e; const float h0 = v[4 * j + e] * rstd * g[c] + bt[c]; u4[e] = h0 * (1.f + sc1[c]) + sh1[c];
            const float* wr = w_in + (size_t)c * PROJ + 2560;
#pragma unroll
            for (int q = 0; q < 16; ++q) dacc[q] += u4[e] * wr[q]; }
        const unsigned lo = (unsigned)f2bf(u4[0]) | ((unsigned)f2bf(u4[1]) << 16), hi = (unsigned)f2bf(u4[2]) | ((unsigned)f2bf(u4[3]) << 16);
        *(uint2*)(U + (size_t)row * D + j * 256 + lane * 4) = make_uint2(lo, hi);
    }
#pragma unroll
    for (int q = 0; q < 16; ++q) { const float t = wave_sum(dacc[q]); if (lane == q) DT[(size_t)row * 16 + q] = softplus_f(t + dt_bias[q]); }
}
struct EpiIn { bf16 *Z, *XBC, *Q, *KV;
    __device__ __forceinline__ void operator()(int r, int c, float v) const {
        if (c < 1024) Z[(size_t)r * 1024 + c] = f2bf(v);
        else if (c < 2560) XBC[(size_t)r * CONVD + (c - 1024)] = f2bf(v);
        else if (c < 3584) Q[(size_t)r * 1024 + (c - 2560)] = f2bf(v * QSCALE);
        else KV[(size_t)r * 256 + (c - 3584)] = f2bf(v); } };
struct EpiF32 { float* O; int ld; const float* bias;
    __device__ __forceinline__ void operator()(int r, int c, float v) const { O[(size_t)r * ld + c] = v + (bias ? bias[c] : 0.f); } };
struct EpiRelu2 { bf16* O; int ld; const float* bias;
    __device__ __forceinline__ void operator()(int r, int c, float v) const { v += bias[c]; v = fmaxf(v, 0.f); O[(size_t)r * ld + c] = f2bf(v * v); } };
template <class Epi>
__global__ void __launch_bounds__(256) k_gemm(const bf16* __restrict__ A, const bf16* __restrict__ Bt, int Mm, int Nn, int Kk, Epi epi) {
    __shared__ float As[32][65], Bs[32][65];
    const int tx = threadIdx.x & 15, ty = threadIdx.x >> 4, m0 = blockIdx.y * 64, n0 = blockIdx.x * 64;
    float acc[4][4];
#pragma unroll
    for (int i = 0; i < 4; ++i)
#pragma unroll
        for (int j = 0; j < 4; ++j) acc[i][j] = 0.f;
    for (int k0 = 0; k0 < Kk; k0 += 32) {
        { const int r = threadIdx.x >> 2, kq = (threadIdx.x & 3) * 8;
          const uint4 a = *(const uint4*)(A + (size_t)(m0 + r) * Kk + k0 + kq), b = *(const uint4*)(Bt + (size_t)(n0 + r) * Kk + k0 + kq);
          const unsigned aw[4] = {a.x, a.y, a.z, a.w}, bw[4] = {b.x, b.y, b.z, b.w};
#pragma unroll
          for (int e = 0; e < 4; ++e) { As[kq + 2 * e][r] = __uint_as_float(aw[e] << 16); As[kq + 2 * e + 1][r] = __uint_as_float(aw[e] & 0xffff0000u);
                                        Bs[kq + 2 * e][r] = __uint_as_float(bw[e] << 16); Bs[kq + 2 * e + 1][r] = __uint_as_float(bw[e] & 0xffff0000u); } }
        __syncthreads();
#pragma unroll 8
        for (int k = 0; k < 32; ++k) {
            float a[4], b[4];
#pragma unroll
            for (int i = 0; i < 4; ++i) { a[i] = As[k][ty * 4 + i]; b[i] = Bs[k][tx * 4 + i]; }
#pragma unroll
            for (int i = 0; i < 4; ++i)
#pragma unroll
                for (int j = 0; j < 4; ++j) acc[i][j] += a[i] * b[j];
        }
        __syncthreads();
    }
#pragma unroll
    for (int i = 0; i < 4; ++i)
#pragma unroll
        for (int j = 0; j < 4; ++j) epi(m0 + ty * 4 + i, n0 + tx * 4 + j, acc[i][j]);
}
__device__ __forceinline__ float conv_silu(const bf16* __restrict__ XBC, const float* __restrict__ cw, const float* __restrict__ cb, int b, int t, int ch) {
    float acc = cb[ch];
#pragma unroll
    for (int k = 0; k < 4; ++k) { const int tt = t - 3 + k; if (tt >= 0) acc += cw[k * CONVD + ch] * bf2f(XBC[((size_t)b * L + tt) * CONVD + ch]); }
    return silu_f(acc);
}
__global__ void __launch_bounds__(256) k_ssd_scan(const bf16* __restrict__ XBC, const float* __restrict__ cw, const float* __restrict__ cb, const float* __restrict__ DT, const float* __restrict__ a_log, bf16* __restrict__ SP) {
    const int idx = blockIdx.x * blockDim.x + threadIdx.x;
    const int n = idx & 127, p = (idx >> 7) & 63, h = (idx >> 13) & 15, b = idx >> 17, g = h >> 3;
    const float A = -__expf(a_log[h]);
    float S = 0.f;
    for (int t = 0; t < L; ++t) {
        if ((t & (CH - 1)) == 0) SP[((((size_t)b * NCH + (t >> 7)) * NH + h) * HD + p) * NST + n] = f2bf(S);
        const float dt = DT[((size_t)b * L + t) * 16 + h];
        const float xv = conv_silu(XBC, cw, cb, b, t, h * 64 + p), bv = conv_silu(XBC, cw, cb, b, t, 1024 + g * 128 + n);
        S = S * __expf(dt * A) + dt * xv * bv;
    }
}
__global__ void __launch_bounds__(256) k_attn(const bf16* __restrict__ Q, const bf16* __restrict__ KV, const float* __restrict__ sinks, bf16* __restrict__ YO) {
    const int wid = blockIdx.x * 4 + (threadIdx.x >> 6), lane = threadIdx.x & 63;
    const int row = wid >> 4, h = wid & 15, kvh = h >> 3, t = row % L;
    const float q = bf2f(Q[(size_t)row * 1024 + h * 64 + lane]);
    const float slope2 = exp2f(-0.5f * (float)(h + 1)) * LOG2E, sink2 = sinks[h] * LOG2E;
    const int nk = t < 127 ? t + 1 : 128;
    float sc0 = -INFINITY, sc1 = -INFINITY;
    for (int i = 0; i < nk; ++i) {
        const float kk = bf2f(KV[(size_t)(row - i) * 256 + kvh * 64 + lane]);
        const float s = wave_sum(q * kk) - slope2 * (float)i;
        if (lane == (i & 63)) { if (i < 64) sc0 = s; else sc1 = s; }
    }
    const float m = fmaxf(wave_max(fmaxf(sc0, sc1)), sink2);
    const float p0 = exp2f(sc0 - m), p1 = exp2f(sc1 - m);
    const float denom = wave_sum(p0 + p1) + exp2f(sink2 - m);
    float o = 0.f;
    for (int i = 0; i < nk; ++i) {
        const float p = __shfl(i < 64 ? p0 : p1, i & 63);
        o += p * bf2f(KV[(size_t)(row - i) * 256 + 128 + kvh * 64 + lane]);
    }
    YO[(size_t)row * 2048 + 1024 + h * 64 + lane] = f2bf(o / denom);
}
__global__ void __launch_bounds__(256) k_cb(const bf16* __restrict__ XBC, const float* __restrict__ cw, const float* __restrict__ cb, bf16* __restrict__ CB) {
    const int idx = blockIdx.x * blockDim.x + threadIdx.x;
    const int s = idx & 127, t = (idx >> 7) & 127, unit = idx >> 14, g = unit & 1, c = (unit >> 1) & 31, b = unit >> 6;
    float acc = 0.f;
    if (s <= t) for (int n = 0; n < NST; ++n)
        acc += conv_silu(XBC, cw, cb, b, c * CH + t, 1280 + g * 128 + n) * conv_silu(XBC, cw, cb, b, c * CH + s, 1024 + g * 128 + n);
    CB[idx] = f2bf(acc);
}
__global__ void __launch_bounds__(256) k_ssd_y(const bf16* __restrict__ XBC, const float* __restrict__ cw, const float* __restrict__ cb, const float* __restrict__ DT, const float* __restrict__ a_log,
                        const float* __restrict__ d_skip, const bf16* __restrict__ CB, const bf16* __restrict__ SP, const bf16* __restrict__ Z, bf16* __restrict__ YO) {
    const size_t idx = (size_t)blockIdx.x * blockDim.x + threadIdx.x;
    const int p = (int)(idx & 63), h = (int)((idx >> 6) & 15), row = (int)(idx >> 10), b = row / L, t = row % L, c = t >> 7, tl = t & 127, g = h >> 3;
    const float A = -__expf(a_log[h]);
    const bf16* cbrow = CB + ((size_t)((b * NCH + c) * 2 + g) * CH + tl) * CH;
    float run = 0.f, y = 0.f;
    for (int s = tl; s >= 0; --s) {
        const int ts = c * CH + s; const float dt = DT[((size_t)b * L + ts) * 16 + h];
        y += bf2f(cbrow[s]) * __expf(run) * dt * conv_silu(XBC, cw, cb, b, ts, h * 64 + p);
        run += dt * A;
    }
    const bf16* sp = SP + ((((size_t)b * NCH + c) * NH + h) * HD + p) * NST;
    float yo = 0.f;
    for (int n = 0; n < NST; ++n) yo += conv_silu(XBC, cw, cb, b, t, 1280 + g * 128 + n) * bf2f(sp[n]);
    y += __expf(run) * yo + d_skip[h] * conv_silu(XBC, cw, cb, b, t, h * 64 + p);
    const float z = bf2f(Z[(size_t)row * 1024 + h * 64 + p]);
    YO[(size_t)row * 2048 + h * 64 + p] = f2bf(y * silu_f(z));
}
__global__ void __launch_bounds__(256) k_gnorm(bf16* __restrict__ YO) {
    const int wid = blockIdx.x * 4 + (threadIdx.x >> 6), lane = threadIdx.x & 63, row = wid >> 1, g = wid & 1;
    bf16* p = YO + (size_t)row * 2048 + g * 512 + lane * 8;
    const uint4 v = *(const uint4*)p; const unsigned w[4] = {v.x, v.y, v.z, v.w}; float f[8]; float s = 0.f;
#pragma unroll
    for (int e = 0; e < 4; ++e) { f[2 * e] = __uint_as_float(w[e] << 16); f[2 * e + 1] = __uint_as_float(w[e] & 0xffff0000u); s += f[2 * e] * f[2 * e] + f[2 * e + 1] * f[2 * e + 1]; }
    const float rstd = rsqrtf(wave_sum(s) * (1.f / 512.f) + RMS_EPS);
    uint4 o; unsigned ow[4];
#pragma unroll
    for (int e = 0; e < 4; ++e) ow[e] = (unsigned)f2bf(f[2 * e] * rstd) | ((unsigned)f2bf(f[2 * e + 1] * rstd) << 16);
    o.x = ow[0]; o.y = ow[1]; o.z = ow[2]; o.w = ow[3]; *(uint4*)p = o;
}
template <int WHICH>
__global__ void __launch_bounds__(256) k_ln_post(const float* __restrict__ x, const float* __restrict__ gin, const float* __restrict__ bin, const float* __restrict__ stats, const float* __restrict__ mod,
                          const float* __restrict__ src, const float* __restrict__ lg, const float* __restrict__ lb, float* __restrict__ out, bf16* __restrict__ U) {
    const int row = blockIdx.x * 4 + (threadIdx.x >> 6), lane = threadIdx.x & 63, b = row / L;
    const float* mb = mod + (size_t)b * 6 * D;
    float v[16]; float s = 0.f;
    const float mean0 = stats[2 * row], rstd0 = stats[2 * row + 1];
#pragma unroll
    for (int j = 0; j < 4; ++j)
#pragma unroll
        for (int e = 0; e < 4; ++e) { const int c = j * 256 + lane * 4 + e; float base;
            if (WHICH == 1) base = (x[(size_t)row * D + c] - mean0) * rstd0 * gin[c] + bin[c]; else base = out[(size_t)row * D + c];
            const float gate = mb[(WHICH == 1 ? 2 : 5) * D + c];
            const float t = ALPHA * base + (1.f + gate) * src[(size_t)row * D + c]; v[4 * j + e] = t; s += t; }
    const float mean = wave_sum(s) * (1.f / D); float s2 = 0.f;
#pragma unroll
    for (int i = 0; i < 16; ++i) { v[i] -= mean; s2 += v[i] * v[i]; }
    const float rstd = rsqrtf(wave_sum(s2) * (1.f / D) + LN_EPS);
#pragma unroll
    for (int j = 0; j < 4; ++j)
#pragma unroll
        for (int e = 0; e < 4; ++e) { const int c = j * 256 + lane * 4 + e; const float h1 = v[4 * j + e] * rstd * lg[c] + lb[c]; out[(size_t)row * D + c] = h1;
            if (WHICH == 1) U[(size_t)row * D + c] = f2bf(h1 * (1.f + mb[4 * D + c]) + mb[3 * D + c]); }
}

extern "C" void kernel_launch(void* const* d_in, const int* in_sizes, int n_in, void* d_out, int out_size, void* d_ws, size_t ws_size, hipStream_t stream) {
    if (n_in != 23 || out_size != M * D || ws_size < WS_END) { fprintf(stderr, "kernel_launch: unexpected shapes (n_in %d out %d ws %zu)\n", n_in, out_size, ws_size); return; }
    const float* x = (const float*)d_in[0]; const float* c = (const float*)d_in[1]; const float* ln_in_g = (const float*)d_in[2]; const float* ln_in_b = (const float*)d_in[3];
    const float* ada_w = (const float*)d_in[4]; const float* ada_b = (const float*)d_in[5]; const float* w_in = (const float*)d_in[6]; const float* conv_w = (const float*)d_in[7];
    const float* conv_b = (const float*)d_in[8]; const float* dt_bias = (const float*)d_in[9]; const float* a_log = (const float*)d_in[10]; const float* d_skip = (const float*)d_in[11];
    const float* norm_w = (const float*)d_in[12]; const float* sinks = (const float*)d_in[13]; const float* w_out = (const float*)d_in[14]; const float* ln1_g = (const float*)d_in[15];
    const float* ln1_b = (const float*)d_in[16]; const float* w_ff1 = (const float*)d_in[17]; const float* b_ff1 = (const float*)d_in[18]; const float* w_ff2 = (const float*)d_in[19];
    const float* b_ff2 = (const float*)d_in[20]; const float* ln2_g = (const float*)d_in[21]; const float* ln2_b = (const float*)d_in[22];
    unsigned char* ws = (unsigned char*)d_ws; float* out = (float*)d_out;
    float* MOD = (float*)(ws + WS_MOD); float* STATS = (float*)(ws + WS_STATS); float* DT = (float*)(ws + WS_DT);
    bf16 *WIN = (bf16*)(ws + WS_WIN), *WOUT = (bf16*)(ws + WS_WOUT), *WFF1 = (bf16*)(ws + WS_WFF1), *WFF2 = (bf16*)(ws + WS_WFF2);
    bf16 *U = (bf16*)(ws + WS_U), *SP = (bf16*)(ws + WS_SPREV), *Z = (bf16*)(ws + WS_Z), *XBC = (bf16*)(ws + WS_XBC), *Q = (bf16*)(ws + WS_Q), *KV = (bf16*)(ws + WS_KV), *CB = (bf16*)(ws + WS_CB);
    bf16 *YO = (bf16*)(ws + WS_YO), *F1 = (bf16*)(ws + WS_F1); float *MIX = (float*)(ws + WS_MIX), *F = (float*)(ws + WS_F);
    auto nblk = [](size_t n, int t) { return (unsigned)((n + t - 1) / t); };
    k_wt<<<nblk((size_t)NP * D, 256), 256, 0, stream>>>(w_in, D, PROJ, WIN, NP, 2560, 16, nullptr, 0);
    k_wt<<<nblk((size_t)D * 2048, 256), 256, 0, stream>>>(w_out, 2048, D, WOUT, D, D, 0, norm_w, 1024);
    k_wt<<<nblk((size_t)DFF * D, 256), 256, 0, stream>>>(w_ff1, D, DFF, WFF1, DFF, DFF, 0, nullptr, 0);
    k_wt<<<nblk((size_t)D * DFF, 256), 256, 0, stream>>>(w_ff2, DFF, D, WFF2, D, D, 0, nullptr, 0);
    k_ada<<<6 * D / 256, 256, 0, stream>>>(c, ada_w, ada_b, MOD);
    k_ln_in<<<M / 4, 256, 0, stream>>>(x, ln_in_g, ln_in_b, MOD, w_in, dt_bias, U, STATS, DT);
    k_gemm<EpiIn><<<dim3(NP / 64, M / 64), 256, 0, stream>>>(U, WIN, M, NP, D, EpiIn{Z, XBC, Q, KV});
    k_ssd_scan<<<NB * NH * HD * NST / 256, 256, 0, stream>>>(XBC, conv_w, conv_b, DT, a_log, SP);
    k_attn<<<M * NH / 4, 256, 0, stream>>>(Q, KV, sinks, YO);
    k_cb<<<NB * NCH * 2 * CH * CH / 256, 256, 0, stream>>>(XBC, conv_w, conv_b, CB);
    k_ssd_y<<<(unsigned)((size_t)M * 1024 / 256), 256, 0, stream>>>(XBC, conv_w, conv_b, DT, a_log, d_skip, CB, SP, Z, YO);
    k_gnorm<<<M * 2 / 4, 256, 0, stream>>>(YO);
    k_gemm<EpiF32><<<dim3(D / 64, M / 64), 256, 0, stream>>>(YO, WOUT, M, D, 2048, EpiF32{MIX, D, nullptr});
    k_ln_post<1><<<M / 4, 256, 0, stream>>>(x, ln_in_g, ln_in_b, STATS, MOD, MIX, ln1_g, ln1_b, out, U);
    k_gemm<EpiRelu2><<<dim3(DFF / 64, M / 64), 256, 0, stream>>>(U, WFF1, M, DFF, D, EpiRelu2{F1, DFF, b_ff1});
    k_gemm<EpiF32><<<dim3(D / 64, M / 64), 256, 0, stream>>>(F1, WFF2, M, D, DFF, EpiF32{F, D, b_ff2});
    k_ln_post<2><<<M / 4, 256, 0, stream>>>(x, ln_in_g, ln_in_b, STATS, MOD, F, ln2_g, ln2_b, out, nullptr);
}
```
